# Optimizing an MI355X kernel written in HIP

```python
import math
import jax
import jax.numpy as jnp
from jax import lax
import numpy as np

D_MODEL = 1024
BATCH = 2
SEQ = 8192
DEPTH = 1

NORM_EPS = 1e-6
D_FF = 2816
MACARON_WEIGHT = 0.5

DN_HEADS = 4
DN_HEAD_DIM = 128
DN_WIDTH = DN_HEADS * DN_HEAD_DIM
DN_CONV = 4
DN_CHUNK = 64

MB_HEADS = 8
MB_HEAD_DIM = 64
MB_WIDTH = MB_HEADS * MB_HEAD_DIM
MB_BLOCK = 256
MB_TOPK = 3
MB_QBLOCK = 64
ALIBI_MAX_BIAS = 8.0

PROJ_WIDTH = 4 * DN_WIDTH + 2 * DN_HEADS + 3 * MB_WIDTH + 2 * D_MODEL

kernel_name = "hybrid_deltanet_moba_macaron"


def rms_norm(x, w):
    xf = x.astype(jnp.float32)
    y = xf * lax.rsqrt(jnp.mean(xf * xf, axis=-1, keepdims=True) + NORM_EPS)
    return (y * w.astype(jnp.float32)).astype(x.dtype)


def l2_normalize(x):
    return x * lax.rsqrt(jnp.sum(x * x, axis=-1, keepdims=True) + NORM_EPS)


def swiglu(h, w_gate, w_up, w_down):
    return (jax.nn.silu(h @ w_gate) * (h @ w_up)) @ w_down


def causal_depthwise_conv(x, w):
    k_len, t_len = w.shape[0], x.shape[1]
    xp = jnp.pad(x, ((0, 0), (k_len - 1, 0), (0, 0)))
    y = xp[:, 0:t_len] * w[0]
    for i in range(1, k_len):
        y = y + xp[:, i:i + t_len] * w[i]
    return y


def split_projection(p):
    sizes = (3 * DN_WIDTH, DN_WIDTH, DN_HEADS, DN_HEADS, MB_WIDTH, MB_WIDTH, MB_WIDTH, D_MODEL, D_MODEL)
    parts, start = [], 0
    for s in sizes:
        parts.append(p[..., start:start + s])
        start += s
    return parts


def chunk_gated_delta_rule(q, k, v, g, beta):
    bsz, nh, t_len, dk = q.shape
    dv = v.shape[-1]
    c = DN_CHUNK
    n = t_len // c
    q = q.reshape(bsz, nh, n, c, dk)
    k = k.reshape(bsz, nh, n, c, dk)
    v = v.reshape(bsz, nh, n, c, dv)
    g = jnp.cumsum(g.reshape(bsz, nh, n, c), axis=-1)
    beta = beta.reshape(bsz, nh, n, c)
    incl = jnp.tril(jnp.ones((c, c), dtype=bool))
    strict = jnp.tril(jnp.ones((c, c), dtype=bool), -1)
    decay = jnp.exp(jnp.where(incl, g[..., :, None] - g[..., None, :], -jnp.inf))
    k_beta = k * beta[..., None]
    v_beta = v * beta[..., None]
    eye = jnp.eye(c, dtype=q.dtype)
    a_mat = jnp.where(strict, jnp.einsum('bhnid,bhnjd->bhnij', k_beta, k) * decay, 0.0) + eye
    t_mat = lax.linalg.triangular_solve(a_mat, jnp.broadcast_to(eye, a_mat.shape),
                                        left_side=True, lower=True, unit_diagonal=True)
    u = t_mat @ v_beta
    w = t_mat @ (k_beta * jnp.exp(g)[..., None])
    attn = jnp.where(incl, jnp.einsum('bhnid,bhnjd->bhnij', q, k) * decay, 0.0)
    q_dec = q * jnp.exp(g)[..., None]
    k_dec = k * jnp.exp(g[..., -1:] - g)[..., None]
    chunk_decay = jnp.exp(g[..., -1])

    def step(state, inp):
        q_i, k_i, u_i, w_i, a_i, d_i = inp
        v_new = u_i - w_i @ state
        o_i = q_i @ state + a_i @ v_new
        state = state * d_i[..., None, None] + jnp.einsum('bhcd,bhce->bhde', k_i, v_new)
        return state, o_i

    xs = (jnp.moveaxis(q_dec, 2, 0), jnp.moveaxis(k_dec, 2, 0), jnp.moveaxis(u, 2, 0),
          jnp.moveaxis(w, 2, 0), jnp.moveaxis(attn, 2, 0), jnp.moveaxis(chunk_decay, 2, 0))
    state0 = jnp.zeros((bsz, nh, dk, dv), q.dtype)
    _, o = lax.scan(step, state0, xs)
    return jnp.moveaxis(o, 0, 2).reshape(bsz, nh, t_len, dv)


def gated_deltanet(qkv, z, b, a, conv_w, a_log, dt_bias, norm_w):
    bsz, t_len, _ = qkv.shape
    qkv = jax.nn.silu(causal_depthwise_conv(qkv, conv_w)).astype(jnp.float32)
    q, k, v = jnp.split(qkv, 3, axis=-1)

    def heads(t):
        return t.reshape(bsz, t_len, DN_HEADS, DN_HEAD_DIM).transpose(0, 2, 1, 3)

    q = l2_normalize(heads(q)) * (DN_HEAD_DIM ** -0.5)
    k = l2_normalize(heads(k))
    v = heads(v)
    beta = jax.nn.sigmoid(b.astype(jnp.float32)).transpose(0, 2, 1)
    g = (-jnp.exp(a_log.astype(jnp.float32))
         * jax.nn.softplus(a.astype(jnp.float32) + dt_bias.astype(jnp.float32))).transpose(0, 2, 1)
    o = chunk_gated_delta_rule(q, k, v, g, beta).transpose(0, 2, 1, 3)
    zg = jax.nn.silu(z.astype(jnp.float32).reshape(bsz, t_len, DN_HEADS, DN_HEAD_DIM))
    o = rms_norm(o, norm_w) * zg
    return o.reshape(bsz, t_len, DN_WIDTH).astype(z.dtype)


def moba_attention(q, k, v):
    bsz, t_len, _ = q.shape
    n_blk = -(-t_len // MB_BLOCK)
    t_pad = n_blk * MB_BLOCK
    topk = min(MB_TOPK, n_blk)

    def heads(t):
        t = jnp.pad(t, ((0, 0), (0, t_pad - t_len), (0, 0)))
        return t.reshape(bsz, t_pad, MB_HEADS, MB_HEAD_DIM).transpose(0, 2, 1, 3)

    q, k, v = heads(q), heads(k), heads(v)
    kb = k.reshape(bsz, MB_HEADS, n_blk, MB_BLOCK, MB_HEAD_DIM)
    vb = v.reshape(bsz, MB_HEADS, n_blk, MB_BLOCK, MB_HEAD_DIM)
    kmean = jnp.mean(kb.astype(jnp.float32), axis=3)
    slopes = jnp.exp2(-ALIBI_MAX_BIAS * jnp.arange(1, MB_HEADS + 1, dtype=jnp.float32) / MB_HEADS)
    scale = MB_HEAD_DIM ** -0.5
    bi = jnp.arange(bsz)[:, None, None, None]
    hi = jnp.arange(MB_HEADS)[None, :, None, None]
    blk_off = jnp.arange(MB_BLOCK)

    def one_qblock(ci):
        start = ci * MB_QBLOCK
        own = start // MB_BLOCK
        q_c = lax.dynamic_slice_in_dim(q, start, MB_QBLOCK, axis=2)
        q_pos = start + jnp.arange(MB_QBLOCK)
        gate = jnp.einsum('bhqd,bhnd->bhqn', q_c.astype(jnp.float32), kmean)
        gate = jnp.where(jnp.arange(n_blk) < own, gate, -jnp.inf)
        _, idx = lax.top_k(gate, topk)
        sel_ok = idx < own
        k_sel = kb[bi, hi, idx]
        v_sel = vb[bi, hi, idx]
        k_pos_sel = idx[..., None] * MB_BLOCK + blk_off
        s_sel = (jnp.einsum('bhqd,bhqnkd->bhqnk', q_c, k_sel).astype(jnp.float32) * scale
                 - slopes[:, None, None, None] * (q_pos[:, None, None] - k_pos_sel))
        s_sel = jnp.where(sel_ok[..., None], s_sel, -jnp.inf)
        k_own = lax.dynamic_slice_in_dim(kb, own, 1, axis=2)[:, :, 0]
        v_own = lax.dynamic_slice_in_dim(vb, own, 1, axis=2)[:, :, 0]
        dist = q_pos[:, None] - (own * MB_BLOCK + blk_off)[None, :]
        s_own = (jnp.einsum('bhqd,bhkd->bhqk', q_c, k_own).astype(jnp.float32) * scale
                 - slopes[:, None, None] * dist)
        s_own = jnp.where(dist >= 0, s_own, -jnp.inf)
        logits = jnp.concatenate(
            [s_sel.reshape(bsz, MB_HEADS, MB_QBLOCK, topk * MB_BLOCK), s_own], axis=-1)
        p = jax.nn.softmax(logits, axis=-1).astype(v.dtype)
        p_sel = p[..., :topk * MB_BLOCK].reshape(bsz, MB_HEADS, MB_QBLOCK, topk, MB_BLOCK)
        p_own = p[..., topk * MB_BLOCK:]
        return (jnp.einsum('bhqnk,bhqnkd->bhqd', p_sel, v_sel)
                + jnp.einsum('bhqk,bhkd->bhqd', p_own, v_own))

    out = lax.map(one_qblock, jnp.arange(t_pad // MB_QBLOCK))
    out = out.transpose(1, 2, 0, 3, 4).reshape(bsz, MB_HEADS, t_pad, MB_HEAD_DIM)[:, :, :t_len]
    return out.transpose(0, 2, 1, 3).reshape(bsz, t_len, MB_WIDTH)


def setup_inputs(seed: int = 0) -> dict:
    key = jax.random.key(seed)
    ks = jax.random.split(key, 24)
    f32 = jnp.float32

    def dense(k, fan_in, fan_out):
        return jax.random.normal(k, (DEPTH, fan_in, fan_out), f32) * fan_in ** -0.5

    def gain(k, n):
        return 1.0 + 0.02 * jax.random.normal(k, (DEPTH, n), f32)

    x = jax.random.normal(ks[0], (BATCH, SEQ, D_MODEL), f32)
    dt = jnp.exp(jax.random.uniform(ks[9], (DEPTH, DN_HEADS), f32, math.log(1e-3), math.log(1e-1)))
    dn_dt_bias = dt + jnp.log(-jnp.expm1(-dt))
    dn_a_log = jnp.log(jax.random.uniform(ks[10], (DEPTH, DN_HEADS), f32, 1.0, 16.0))
    return {
        'x': x,
        'ffn1_pre_w': gain(ks[1], D_MODEL),
        'ffn1_w_gate': dense(ks[2], D_MODEL, D_FF),
        'ffn1_w_up': dense(ks[3], D_MODEL, D_FF),
        'ffn1_w_down': dense(ks[4], D_FF, D_MODEL),
        'ffn1_post_w': gain(ks[5], D_MODEL),
        'mix_pre_w': gain(ks[6], D_MODEL),
        'w_in': dense(ks[7], D_MODEL, PROJ_WIDTH),
        'dn_conv_w': jax.random.normal(ks[8], (DEPTH, DN_CONV, 3 * DN_WIDTH), f32) * DN_CONV ** -0.5,
        'dn_a_log': dn_a_log,
        'dn_dt_bias': dn_dt_bias,
        'dn_norm_w': gain(ks[11], DN_HEAD_DIM),
        'w_branch_dn': dense(ks[12], DN_WIDTH, D_MODEL),
        'w_branch_mb': dense(ks[13], MB_WIDTH, D_MODEL),
        'w_out': dense(ks[14], D_MODEL, D_MODEL),
        'mix_post_w': gain(ks[15], D_MODEL),
        'ffn2_pre_w': gain(ks[16], D_MODEL),
        'ffn2_w_gate': dense(ks[17], D_MODEL, D_FF),
        'ffn2_w_up': dense(ks[18], D_MODEL, D_FF),
        'ffn2_w_down': dense(ks[19], D_FF, D_MODEL),
        'ffn2_post_w': gain(ks[20], D_MODEL),
    }


def reference(x, ffn1_pre_w, ffn1_w_gate, ffn1_w_up, ffn1_w_down, ffn1_post_w,
              mix_pre_w, w_in, dn_conv_w, dn_a_log, dn_dt_bias, dn_norm_w,
              w_branch_dn, w_branch_mb, w_out, mix_post_w,
              ffn2_pre_w, ffn2_w_gate, ffn2_w_up, ffn2_w_down, ffn2_post_w):
    for l in range(DEPTH):
        h = swiglu(rms_norm(x, ffn1_pre_w[l]), ffn1_w_gate[l], ffn1_w_up[l], ffn1_w_down[l])
        x = x + MACARON_WEIGHT * rms_norm(h, ffn1_post_w[l])
        h = rms_norm(x, mix_pre_w[l])
        dn_qkv, dn_z, dn_b, dn_a, mb_q, mb_k, mb_v, gate_dn, gate_mb = split_projection(h @ w_in[l])
        y_dn = gated_deltanet(dn_qkv, dn_z, dn_b, dn_a, dn_conv_w[l], dn_a_log[l],
                              dn_dt_bias[l], dn_norm_w[l]) @ w_branch_dn[l]
        y_mb = moba_attention(mb_q, mb_k, mb_v) @ w_branch_mb[l]
        merged = jax.nn.sigmoid(gate_dn) * y_dn + jax.nn.sigmoid(gate_mb) * y_mb
        x = x + rms_norm(merged @ w_out[l], mix_post_w[l])
        h = swiglu(rms_norm(x, ffn2_pre_w[l]), ffn2_w_gate[l], ffn2_w_up[l], ffn2_w_down[l])
        x = x + MACARON_WEIGHT * rms_norm(h, ffn2_post_w[l])
    return x
```

```cpp
#include <hip/hip_runtime.h>
#include <stdint.h>

typedef unsigned short bf16_t;
typedef short bf16x8 __attribute__((ext_vector_type(8)));
typedef float f32x4 __attribute__((ext_vector_type(4)));

constexpr int DM = 1024, NB = 2, T = 8192, DFF = 2816;
constexpr int PROJ_W = 5640, PW = 5632;
constexpr int PC_Z = 1536, PC_MQ = 2048, PC_MK = 2560, PC_MV = 3072, PC_GD = 3584, PC_GM = 4608;

__device__ __forceinline__ bf16_t f2bf(float f) { unsigned u = __builtin_bit_cast(unsigned, f); return (bf16_t)((u + 0x7fffu + ((u >> 16) & 1u)) >> 16); }
__device__ __forceinline__ float bf2f(bf16_t b) { return __builtin_bit_cast(float, (unsigned)b << 16); }
__device__ __forceinline__ float wave_sum(float v) {
#pragma unroll
    for (int o = 1; o < 64; o <<= 1) v += __shfl_xor(v, o);
    return v;
}
__device__ __forceinline__ float wave_max(float v) {
#pragma unroll
    for (int o = 1; o < 64; o <<= 1) v = fmaxf(v, __shfl_xor(v, o));
    return v;
}
__device__ __forceinline__ float sigmoidf_(float x) { return 1.f / (1.f + expf(-x)); }
__device__ __forceinline__ float siluf_(float x) { return x / (1.f + expf(-x)); }

__global__ void __launch_bounds__(256) rms_rows_bf16(const float* __restrict__ in, const float* __restrict__ w, bf16_t* __restrict__ out, int nrows) {
    const int row = blockIdx.x * 4 + (threadIdx.x >> 6), lane = threadIdx.x & 63;
    if (row >= nrows) return;
    const float4* p = (const float4*)(in + (size_t)row * DM);
    float4 v[4]; float ss = 0.f;
#pragma unroll
    for (int j = 0; j < 4; ++j) { v[j] = p[lane + 64 * j]; ss += v[j].x * v[j].x + v[j].y * v[j].y + v[j].z * v[j].z + v[j].w * v[j].w; }
    ss = wave_sum(ss);
    const float r = rsqrtf(ss * (1.f / DM) + 1e-6f);
#pragma unroll
    for (int j = 0; j < 4; ++j) {
        const float4 ww = ((const float4*)w)[lane + 64 * j];
        bf16_t* o = out + (size_t)row * DM + (lane + 64 * j) * 4;
        o[0] = f2bf(v[j].x * r * ww.x); o[1] = f2bf(v[j].y * r * ww.y); o[2] = f2bf(v[j].z * r * ww.z); o[3] = f2bf(v[j].w * r * ww.w);
    }
}
__global__ void __launch_bounds__(256) post_res_norm(const float* __restrict__ y, const float* __restrict__ postw, float coef, const float* xin, float* xout,
                                                       const float* __restrict__ prew, bf16_t* __restrict__ xn, int nrows) {
    const int row = blockIdx.x * 4 + (threadIdx.x >> 6), lane = threadIdx.x & 63;
    if (row >= nrows) return;
    const float4* p = (const float4*)(y + (size_t)row * DM);
    float4 v[4]; float ss = 0.f;
#pragma unroll
    for (int j = 0; j < 4; ++j) { v[j] = p[lane + 64 * j]; ss += v[j].x * v[j].x + v[j].y * v[j].y + v[j].z * v[j].z + v[j].w * v[j].w; }
    ss = wave_sum(ss);
    const float r = rsqrtf(ss * (1.f / DM) + 1e-6f) * coef;
    float4 xo[4]; float s2 = 0.f;
#pragma unroll
    for (int j = 0; j < 4; ++j) {
        const float4 ww = ((const float4*)postw)[lane + 64 * j];
        const float4 xi = ((const float4*)(xin + (size_t)row * DM))[lane + 64 * j];
        xo[j].x = xi.x + v[j].x * r * ww.x; xo[j].y = xi.y + v[j].y * r * ww.y; xo[j].z = xi.z + v[j].z * r * ww.z; xo[j].w = xi.w + v[j].w * r * ww.w;
        s2 += xo[j].x * xo[j].x + xo[j].y * xo[j].y + xo[j].z * xo[j].z + xo[j].w * xo[j].w;
    }
#pragma unroll
    for (int j = 0; j < 4; ++j) ((float4*)(xout + (size_t)row * DM))[lane + 64 * j] = xo[j];
    if (prew) {
        s2 = wave_sum(s2);
        const float r2 = rsqrtf(s2 * (1.f / DM) + 1e-6f);
#pragma unroll
        for (int j = 0; j < 4; ++j) {
            const float4 ww = ((const float4*)prew)[lane + 64 * j];
            bf16_t* o = xn + (size_t)row * DM + (lane + 64 * j) * 4;
            o[0] = f2bf(xo[j].x * r2 * ww.x); o[1] = f2bf(xo[j].y * r2 * ww.y); o[2] = f2bf(xo[j].z * r2 * ww.z); o[3] = f2bf(xo[j].w * r2 * ww.w);
        }
    }
}

template <int MODE>
__global__ void __launch_bounds__(256) gemm_v1(const bf16_t* __restrict__ A, int lda, const float* __restrict__ B, const float* __restrict__ B2, int ldb,
                                                 int M, int N, int K, float* __restrict__ C0, bf16_t* __restrict__ Cb, int ldc) {
    __shared__ __attribute__((aligned(16))) bf16_t As[128][40];
    __shared__ __attribute__((aligned(16))) bf16_t Bs[128][40];
    __shared__ __attribute__((aligned(16))) bf16_t Bs2[MODE == 1 ? 128 : 1][40];
    const int tid = threadIdx.x, lane = tid & 63, wid = tid >> 6, wm = wid >> 1, wn = wid & 1;
    const int m0 = blockIdx.y * 128, n0 = blockIdx.x * 128;
    f32x4 acc[4][4], acc2[MODE == 1 ? 4 : 1][MODE == 1 ? 4 : 1];
#pragma unroll
    for (int i = 0; i < 4; ++i)
#pragma unroll
        for (int j = 0; j < 4; ++j) acc[i][j] = (f32x4){0.f, 0.f, 0.f, 0.f};
    if (MODE == 1) {
#pragma unroll
        for (int i = 0; i < 4; ++i)
#pragma unroll
            for (int j = 0; j < 4; ++j) acc2[MODE == 1 ? i : 0][MODE == 1 ? j : 0] = (f32x4){0.f, 0.f, 0.f, 0.f};
    }
    for (int k0 = 0; k0 < K; k0 += 32) {
#pragma unroll
        for (int i = 0; i < 2; ++i) {
            const int id = tid + 256 * i, row = id >> 2, kc = id & 3;
            const uint4 v = *(const uint4*)(A + (size_t)(m0 + row) * lda + k0 + kc * 8);
            *(uint4*)&As[row][kc * 8] = v;
        }
#pragma unroll
        for (int i = 0; i < 4; ++i) {
            const int id = tid + 256 * i, kr = id >> 5, nc = id & 31, col = n0 + nc * 4;
            float4 v = make_float4(0.f, 0.f, 0.f, 0.f);
            if (col + 3 < N) v = *(const float4*)(B + (size_t)(k0 + kr) * ldb + col);
            Bs[nc * 4 + 0][kr] = f2bf(v.x); Bs[nc * 4 + 1][kr] = f2bf(v.y); Bs[nc * 4 + 2][kr] = f2bf(v.z); Bs[nc * 4 + 3][kr] = f2bf(v.w);
            if (MODE == 1) {
                float4 u = make_float4(0.f, 0.f, 0.f, 0.f);
                if (col + 3 < N) u = *(const float4*)(B2 + (size_t)(k0 + kr) * ldb + col);
                Bs2[MODE == 1 ? nc * 4 + 0 : 0][kr] = f2bf(u.x); Bs2[MODE == 1 ? nc * 4 + 1 : 0][kr] = f2bf(u.y);
                Bs2[MODE == 1 ? nc * 4 + 2 : 0][kr] = f2bf(u.z); Bs2[MODE == 1 ? nc * 4 + 3 : 0][kr] = f2bf(u.w);
            }
        }
        __syncthreads();
        bf16x8 a[4], b[4];
#pragma unroll
        for (int i = 0; i < 4; ++i) a[i] = *(const bf16x8*)&As[wm * 64 + i * 16 + (lane & 15)][8 * (lane >> 4)];
#pragma unroll
        for (int j = 0; j < 4; ++j) b[j] = *(const bf16x8*)&Bs[wn * 64 + j * 16 + (lane & 15)][8 * (lane >> 4)];
#pragma unroll
        for (int i = 0; i < 4; ++i)
#pragma unroll
            for (int j = 0; j < 4; ++j) acc[i][j] = __builtin_amdgcn_mfma_f32_16x16x32_bf16(a[i], b[j], acc[i][j], 0, 0, 0);
        if (MODE == 1) {
#pragma unroll
            for (int j = 0; j < 4; ++j) b[j] = *(const bf16x8*)&Bs2[MODE == 1 ? wn * 64 + j * 16 + (lane & 15) : 0][8 * (lane >> 4)];
#pragma unroll
            for (int i = 0; i < 4; ++i)
#pragma unroll
                for (int j = 0; j < 4; ++j) acc2[MODE == 1 ? i : 0][MODE == 1 ? j : 0] = __builtin_amdgcn_mfma_f32_16x16x32_bf16(a[i], b[j], acc2[MODE == 1 ? i : 0][MODE == 1 ? j : 0], 0, 0, 0);
        }
        __syncthreads();
    }
#pragma unroll
    for (int i = 0; i < 4; ++i)
#pragma unroll
        for (int j = 0; j < 4; ++j)
#pragma unroll
            for (int r = 0; r < 4; ++r) {
                const int row = m0 + wm * 64 + i * 16 + (lane >> 4) * 4 + r, col = n0 + wn * 64 + j * 16 + (lane & 15);
                if (col >= N) continue;
                const float v = acc[i][j][r];
                if (MODE == 0) C0[(size_t)row * ldc + col] = v;
                else if (MODE == 1) { const float u = acc2[MODE == 1 ? i : 0][MODE == 1 ? j : 0][r]; Cb[(size_t)row * ldc + col] = f2bf(siluf_(v) * u); }
                else {
                    if (col < 2048) Cb[(size_t)row * PW + col] = f2bf(v);
                    else if (col < 2056) C0[(size_t)row * 8 + (col - 2048)] = v;
                    else Cb[(size_t)row * PW + (col - 8)] = f2bf(v);
                }
            }
}

__global__ void __launch_bounds__(256) dn_conv(const bf16_t* __restrict__ P, const float* __restrict__ convw, float* __restrict__ qkv) {
    const int idx = blockIdx.x * 256 + threadIdx.x, t = idx / 1536, c = idx % 1536;
    float acc = 0.f;
#pragma unroll
    for (int i = 0; i < 4; ++i) { const int tt = t - 3 + i; if (tt >= 0) acc += convw[i * 1536 + c] * bf2f(P[(size_t)tt * PW + c]); }
    qkv[idx] = siluf_(acc);
}
__global__ void __launch_bounds__(256) dn_l2norm(float* __restrict__ qkv) {
    const int w = blockIdx.x * 4 + (threadIdx.x >> 6), lane = threadIdx.x & 63;
    const int t = w >> 3, h = (w >> 1) & 3, which = w & 1;
    float2* p = (float2*)(qkv + (size_t)t * 1536 + which * 512 + h * 128) + lane;
    float2 v = *p;
    const float ss = wave_sum(v.x * v.x + v.y * v.y);
    float r = rsqrtf(ss + 1e-6f);
    if (which == 0) r *= 0.08838834764831845f;
    v.x *= r; v.y *= r; *p = v;
}
__global__ void __launch_bounds__(256) dn_betag(const float* __restrict__ BA, const float* __restrict__ a_log, const float* __restrict__ dt_bias, float* __restrict__ beta, float* __restrict__ g) {
    const int idx = blockIdx.x * 256 + threadIdx.x, t = idx >> 2, h = idx & 3;
    beta[idx] = sigmoidf_(BA[(size_t)t * 8 + h]);
    const float x = BA[(size_t)t * 8 + 4 + h] + dt_bias[h];
    const float sp = x > 20.f ? x : log1pf(expf(x));
    g[idx] = -expf(a_log[h]) * sp;
}
__global__ void __launch_bounds__(256) dn_recur(const float* __restrict__ qkv, const float* __restrict__ beta, const float* __restrict__ g, float* __restrict__ o) {
    const int w = blockIdx.x * 4 + (threadIdx.x >> 6), lane = threadIdx.x & 63;
    const int h = w >> 7, j = w & 127;
    float s0 = 0.f, s1 = 0.f;
    for (int t0 = 0; t0 < T; t0 += 8) {
        float2 k2[8], q2[8]; float vj[8], eg[8], bb[8];
#pragma unroll
        for (int i = 0; i < 8; ++i) {
            const float* row = qkv + (size_t)(t0 + i) * 1536;
            q2[i] = *(const float2*)(row + h * 128 + 2 * lane);
            k2[i] = *(const float2*)(row + 512 + h * 128 + 2 * lane);
            vj[i] = row[1024 + h * 128 + j];
            eg[i] = expf(g[(t0 + i) * 4 + h]); bb[i] = beta[(t0 + i) * 4 + h];
        }
#pragma unroll
        for (int i = 0; i < 8; ++i) {
            const float dot = wave_sum(k2[i].x * s0 + k2[i].y * s1);
            const float c = bb[i] * (vj[i] - eg[i] * dot);
            s0 = eg[i] * s0 + c * k2[i].x; s1 = eg[i] * s1 + c * k2[i].y;
            const float ov = wave_sum(q2[i].x * s0 + q2[i].y * s1);
            if (lane == 0) o[(size_t)(t0 + i) * 512 + h * 128 + j] = ov;
        }
    }
}
__global__ void __launch_bounds__(256) dn_outnorm(const float* __restrict__ o, const float* __restrict__ normw, const bf16_t* __restrict__ P, bf16_t* __restrict__ dn_out) {
    const int w = blockIdx.x * 4 + (threadIdx.x >> 6), lane = threadIdx.x & 63;
    const int t = w >> 2, h = w & 3;
    const float2 v = *((const float2*)(o + (size_t)t * 512 + h * 128) + lane);
    const float ss = wave_sum(v.x * v.x + v.y * v.y);
    const float r = rsqrtf(ss * (1.f / 128.f) + 1e-6f);
    const bf16_t* z = P + (size_t)t * PW + PC_Z + h * 128 + 2 * lane;
    bf16_t* d = dn_out + (size_t)t * 512 + h * 128 + 2 * lane;
    d[0] = f2bf(v.x * r * normw[2 * lane] * siluf_(bf2f(z[0])));
    d[1] = f2bf(v.y * r * normw[2 * lane + 1] * siluf_(bf2f(z[1])));
}

__global__ void __launch_bounds__(256) mb_kmean(const bf16_t* __restrict__ P, float* __restrict__ kmean) {
    __shared__ float red[4][64];
    const int h = blockIdx.x >> 5, n = blockIdx.x & 31, d = threadIdx.x & 63, part = threadIdx.x >> 6;
    float s = 0.f;
    for (int i = 0; i < 64; ++i) s += bf2f(P[(size_t)(n * 256 + part * 64 + i) * PW + PC_MK + h * 64 + d]);
    red[part][d] = s; __syncthreads();
    if (part == 0) kmean[(h * 32 + n) * 64 + d] = (red[0][d] + red[1][d] + red[2][d] + red[3][d]) * (1.f / 256.f);
}
__global__ void __launch_bounds__(256) mb_attn(const bf16_t* __restrict__ P, const float* __restrict__ kmean, bf16_t* __restrict__ mb_out) {
    __shared__ float pl[4][1024];
    const int wv = threadIdx.x >> 6, lane = threadIdx.x & 63;
    const int w = blockIdx.x * 4 + wv, h = w / T, t = w % T, own = t >> 8;
    float* pp = pl[wv];
    float q[64];
    {
        const uint4* qp = (const uint4*)(P + (size_t)t * PW + PC_MQ + h * 64);
#pragma unroll
        for (int i = 0; i < 8; ++i) { const uint4 u = qp[i];
            q[i * 8 + 0] = bf2f((bf16_t)(u.x & 0xffff)); q[i * 8 + 1] = bf2f((bf16_t)(u.x >> 16)); q[i * 8 + 2] = bf2f((bf16_t)(u.y & 0xffff)); q[i * 8 + 3] = bf2f((bf16_t)(u.y >> 16));
            q[i * 8 + 4] = bf2f((bf16_t)(u.z & 0xffff)); q[i * 8 + 5] = bf2f((bf16_t)(u.z >> 16)); q[i * 8 + 6] = bf2f((bf16_t)(u.w & 0xffff)); q[i * 8 + 7] = bf2f((bf16_t)(u.w >> 16)); }
    }
    float val = -INFINITY;
    if (lane < 32 && lane < own) { const float* km = kmean + (h * 32 + lane) * 64; float s = 0.f;
#pragma unroll
        for (int d = 0; d < 64; ++d) s += q[d] * km[d];
        val = s; }
    int sel[4]; int ns = 0;
    for (int r = 0; r < 3; ++r) {
        const float m = wave_max(val);
        if (m == -INFINITY) break;
        const unsigned long long mask = __ballot(val == m);
        const int idx = __ffsll((long long)mask) - 1;
        sel[ns++] = idx;
        if (lane == idx) val = -INFINITY;
    }
    sel[ns++] = own;
    const float slope = exp2f(-(float)(h + 1));
    float lmax = -INFINITY;
    for (int s = 0; s < ns; ++s) {
        const int blk = sel[s];
#pragma unroll
        for (int kk = 0; kk < 4; ++kk) {
            const int key = blk * 256 + kk * 64 + lane;
            const uint4* kp = (const uint4*)(P + (size_t)key * PW + PC_MK + h * 64);
            float dot = 0.f;
#pragma unroll
            for (int i = 0; i < 8; ++i) { const uint4 u = kp[i];
                dot += q[i * 8 + 0] * bf2f((bf16_t)(u.x & 0xffff)) + q[i * 8 + 1] * bf2f((bf16_t)(u.x >> 16)) + q[i * 8 + 2] * bf2f((bf16_t)(u.y & 0xffff)) + q[i * 8 + 3] * bf2f((bf16_t)(u.y >> 16))
                     + q[i * 8 + 4] * bf2f((bf16_t)(u.z & 0xffff)) + q[i * 8 + 5] * bf2f((bf16_t)(u.z >> 16)) + q[i * 8 + 6] * bf2f((bf16_t)(u.w & 0xffff)) + q[i * 8 + 7] * bf2f((bf16_t)(u.w >> 16)); }
            float sc = dot * 0.125f - slope * (float)(t - key);
            if (key > t) sc = -INFINITY;
            pp[s * 256 + kk * 64 + lane] = sc;
            lmax = fmaxf(lmax, sc);
        }
    }
    const float m = wave_max(lmax);
    float lsum = 0.f;
    for (int e = lane; e < ns * 256; e += 64) { const float pe = expf(pp[e] - m); pp[e] = pe; lsum += pe; }
    const float l = wave_sum(lsum);
    __builtin_amdgcn_s_waitcnt(0);
    float acc = 0.f;
    for (int s = 0; s < ns; ++s) {
        const bf16_t* vp = P + (size_t)(sel[s] * 256) * PW + PC_MV + h * 64 + lane;
        for (int kk = 0; kk < 256; ++kk) { const float pe = pp[s * 256 + kk]; acc += pe * bf2f(vp[(size_t)kk * PW]); }
    }
    mb_out[(size_t)t * 512 + h * 64 + lane] = f2bf(acc / l);
}
__global__ void __launch_bounds__(256) gate_merge(const float* __restrict__ ydn, const float* __restrict__ ymb, const bf16_t* __restrict__ P, bf16_t* __restrict__ merged) {
    const int idx = blockIdx.x * 256 + threadIdx.x, t = idx >> 10, c = idx & 1023;
    const float gd = bf2f(P[(size_t)t * PW + PC_GD + c]), gm = bf2f(P[(size_t)t * PW + PC_GM + c]);
    merged[idx] = f2bf(sigmoidf_(gd) * ydn[idx] + sigmoidf_(gm) * ymb[idx]);
}

extern "C" void kernel_launch(void* const* d_in, const int* in_sizes, int n_in, void* d_out, int out_size, void* d_ws, size_t ws_size, hipStream_t stream) {
    const float* x = (const float*)d_in[0];
    const float* ffn1_pre_w = (const float*)d_in[1]; const float* ffn1_wg = (const float*)d_in[2]; const float* ffn1_wu = (const float*)d_in[3];
    const float* ffn1_wd = (const float*)d_in[4]; const float* ffn1_post_w = (const float*)d_in[5]; const float* mix_pre_w = (const float*)d_in[6];
    const float* w_in = (const float*)d_in[7]; const float* dn_conv_w = (const float*)d_in[8]; const float* dn_a_log = (const float*)d_in[9];
    const float* dn_dt_bias = (const float*)d_in[10]; const float* dn_norm_w = (const float*)d_in[11]; const float* w_bdn = (const float*)d_in[12];
    const float* w_bmb = (const float*)d_in[13]; const float* w_out = (const float*)d_in[14]; const float* mix_post_w = (const float*)d_in[15];
    const float* ffn2_pre_w = (const float*)d_in[16]; const float* ffn2_wg = (const float*)d_in[17]; const float* ffn2_wu = (const float*)d_in[18];
    const float* ffn2_wd = (const float*)d_in[19]; const float* ffn2_post_w = (const float*)d_in[20];
    float* out = (float*)d_out;
    char* ws = (char*)d_ws;
    const size_t MiB = 1u << 20;
    bf16_t* XN = (bf16_t*)(ws + 0 * MiB);
    bf16_t* HP = (bf16_t*)(ws + 16 * MiB);
    float* Y = (float*)(ws + 104 * MiB);
    float* QKV = (float*)(ws + 136 * MiB);
    float* O = (float*)(ws + 184 * MiB);
    bf16_t* DNOUT = (bf16_t*)(ws + 200 * MiB);
    bf16_t* MBOUT = (bf16_t*)(ws + 208 * MiB);
    float* BA = (float*)(ws + 216 * MiB);
    float* BETA = (float*)(ws + 217 * MiB);
    float* G = (float*)(ws + 218 * MiB);
    float* KMEAN = (float*)(ws + 219 * MiB);
    float* YMB = QKV; bf16_t* MERGED = (bf16_t*)O;
    for (int b = 0; b < NB; ++b) {
        const float* xb = x + (size_t)b * T * DM; float* ob = out + (size_t)b * T * DM;
        rms_rows_bf16<<<T / 4, 256, 0, stream>>>(xb, ffn1_pre_w, XN, T);
        gemm_v1<1><<<dim3(DFF / 128, T / 128), 256, 0, stream>>>(XN, DM, ffn1_wg, ffn1_wu, DFF, T, DFF, DM, nullptr, HP, DFF);
        gemm_v1<0><<<dim3(DM / 128, T / 128), 256, 0, stream>>>(HP, DFF, ffn1_wd, nullptr, DM, T, DM, DFF, Y, nullptr, DM);
        post_res_norm<<<T / 4, 256, 0, stream>>>(Y, ffn1_post_w, 0.5f, xb, ob, mix_pre_w, XN, T);
        gemm_v1<2><<<dim3((PROJ_W + 127) / 128, T / 128), 256, 0, stream>>>(XN, DM, w_in, nullptr, PROJ_W, T, PROJ_W, DM, BA, HP, PW);
        dn_conv<<<T * 1536 / 256, 256, 0, stream>>>(HP, dn_conv_w, QKV);
        dn_l2norm<<<T * 8 / 4, 256, 0, stream>>>(QKV);
        dn_betag<<<T * 4 / 256, 256, 0, stream>>>(BA, dn_a_log, dn_dt_bias, BETA, G);
        dn_recur<<<512 / 4, 256, 0, stream>>>(QKV, BETA, G, O);
        dn_outnorm<<<T * 4 / 4, 256, 0, stream>>>(O, dn_norm_w, HP, DNOUT);
        mb_kmean<<<8 * 32, 256, 0, stream>>>(HP, KMEAN);
        mb_attn<<<T * 8 / 4, 256, 0, stream>>>(HP, KMEAN, MBOUT);
        gemm_v1<0><<<dim3(DM / 128, T / 128), 256, 0, stream>>>(DNOUT, 512, w_bdn, nullptr, DM, T, DM, 512, Y, nullptr, DM);
        gemm_v1<0><<<dim3(DM / 128, T / 128), 256, 0, stream>>>(MBOUT, 512, w_bmb, nullptr, DM, T, DM, 512, YMB, nullptr, DM);
        gate_merge<<<T * DM / 256, 256, 0, stream>>>(Y, YMB, HP, MERGED);
        gemm_v1<0><<<dim3(DM / 128, T / 128), 256, 0, stream>>>(MERGED, DM, w_out, nullptr, DM, T, DM, DM, Y, nullptr, DM);
        post_res_norm<<<T / 4, 256, 0, stream>>>(Y, mix_post_w, 1.0f, ob, ob, ffn2_pre_w, XN, T);
        gemm_v1<1><<<dim3(DFF / 128, T / 128), 256, 0, stream>>>(XN, DM, ffn2_wg, ffn2_wu, DFF, T, DFF, DM, nullptr, HP, DFF);
        gemm_v1<0><<<dim3(DM / 128, T / 128), 256, 0, stream>>>(HP, DFF, ffn2_wd, nullptr, DM, T, DM, DFF, Y, nullptr, DM);
        post_res_norm<<<T / 4, 256, 0, stream>>>(Y, ffn2_post_w, 0.5f, ob, ob, nullptr, nullptr, T);
    }
}
```
